# Optimizing an MI355X kernel written in HIP

```python
import jax, jax.numpy as jnp
from jax import lax
import numpy as np

D_MODEL = 1024
BATCH = 8
SEQ = 4096
DEPTH = 1

MEM_LEN = 256
EPS = 1e-6

LRU_WIDTH = D_MODEL
LRU_HEADS = 8
LRU_HEAD_DIM = LRU_WIDTH // LRU_HEADS
CONV_WIDTH = 4
LRU_C = 8.0

GLA_HEADS = 4
GLA_DV = D_MODEL // 8
GLA_DK = GLA_DV // 2
GLA_V_WIDTH = GLA_HEADS * GLA_DV
GLA_K_WIDTH = GLA_HEADS * GLA_DK
GLA_RANK = 16
GLA_TAU = 16.0
GLA_CHUNK = 64

XA_HEADS = 4
XA_HEAD_DIM = D_MODEL // 8
XA_WIDTH = XA_HEADS * XA_HEAD_DIM

MIX_WIDTH = LRU_WIDTH + GLA_V_WIDTH + XA_WIDTH
IN_SIZES = (LRU_WIDTH, GLA_K_WIDTH, GLA_K_WIDTH, GLA_V_WIDTH, GLA_RANK, XA_WIDTH, MIX_WIDTH)
IN_WIDTH = LRU_WIDTH + 2 * GLA_K_WIDTH + GLA_V_WIDTH + GLA_RANK + XA_WIDTH + MIX_WIDTH

kernel_name = "hybrid_rglru_gla_memxattn_parallel_heads"


def rms_norm(x, g):
    x32 = x.astype(jnp.float32)
    y = x32 * lax.rsqrt(jnp.mean(x32 * x32, axis=-1, keepdims=True) + EPS)
    return (y * g.astype(jnp.float32)).astype(x.dtype)


def causal_depthwise_conv(u, w, b):
    c = u.shape[-1]
    y = lax.conv_general_dilated(
        u, w[:, None, :].astype(u.dtype), window_strides=(1,),
        padding=[(CONV_WIDTH - 1, 0)], dimension_numbers=("NWC", "WIO", "NWC"),
        feature_group_count=c)
    return y + b.astype(u.dtype)


def rg_lru(u, w_a, b_a, w_i, b_i, lam):
    bsz, s, _ = u.shape
    uh = u.reshape(bsz, s, LRU_HEADS, LRU_HEAD_DIM)
    r = jax.nn.sigmoid((jnp.einsum("bshi,hij->bshj", uh, w_a) + b_a).astype(jnp.float32))
    i = jax.nn.sigmoid((jnp.einsum("bshi,hij->bshj", uh, w_i) + b_i).astype(jnp.float32))
    r = r.reshape(bsz, s, LRU_WIDTH)
    i = i.reshape(bsz, s, LRU_WIDTH)
    log_a = -LRU_C * r * jax.nn.softplus(-lam.astype(jnp.float32))
    a = jnp.exp(log_a)
    mult = jnp.sqrt(-jnp.expm1(2.0 * log_a))
    bx = mult * (i * u.astype(jnp.float32))

    def combine(left, right):
        a1, b1 = left
        a2, b2 = right
        return a1 * a2, a2 * b1 + b2

    _, h = lax.associative_scan(combine, (a, bx), axis=1)
    return h.astype(u.dtype)


def gla(q, k, v, g_lr, w_g2, b_g, norm_g):
    bsz, s, _ = q.shape
    n, c = s // GLA_CHUNK, GLA_CHUNK
    f32 = jnp.float32
    q = q.astype(f32).reshape(bsz, n, c, GLA_HEADS, GLA_DK) * (GLA_DK ** -0.5)
    k = k.astype(f32).reshape(bsz, n, c, GLA_HEADS, GLA_DK)
    v = v.astype(f32).reshape(bsz, n, c, GLA_HEADS, GLA_DV)
    logit = (g_lr @ w_g2 + b_g).astype(f32)
    log_alpha = jax.nn.log_sigmoid(logit) / GLA_TAU
    cum = jnp.cumsum(log_alpha.reshape(bsz, n, c, GLA_HEADS, GLA_DK), axis=2)
    cum_last = cum[:, :, -1:]
    q_dec = q * jnp.exp(cum)
    k_dec = k * jnp.exp(-cum)
    causal = jnp.tril(jnp.ones((c, c), dtype=bool))
    att = jnp.einsum("bnihk,bnjhk->bnhij", q_dec, k_dec)
    att = jnp.where(causal, att, 0.0)
    o_intra = jnp.einsum("bnhij,bnjhv->bnihv", att, v)
    kv = jnp.einsum("bnjhk,bnjhv->nbhkv", k * jnp.exp(cum_last - cum), v)
    decay = jnp.exp(cum_last[:, :, 0]).transpose(1, 0, 2, 3)

    def step(state, inp):
        d, kv_n = inp
        return d[..., None] * state + kv_n, state

    s0 = jnp.zeros((bsz, GLA_HEADS, GLA_DK, GLA_DV), f32)
    _, s_prev = lax.scan(step, s0, (decay, kv))
    o_inter = jnp.einsum("bnihk,nbhkv->bnihv", q_dec, s_prev)
    o = (o_intra + o_inter).reshape(bsz, s, GLA_HEADS, GLA_DV)
    o = o * lax.rsqrt(jnp.mean(o * o, axis=-1, keepdims=True) + EPS)
    o = o * norm_g.astype(f32).reshape(GLA_HEADS, GLA_DV)
    return o.reshape(bsz, s, GLA_V_WIDTH).astype(g_lr.dtype)


def memory_cross_attention(q, mem_n, w_mem_kv):
    bsz, s, _ = q.shape
    m = mem_n.shape[1]
    kvm = mem_n @ w_mem_kv
    km, vm = jnp.split(kvm, 2, axis=-1)
    qh = q.reshape(bsz, s, XA_HEADS, XA_HEAD_DIM)
    kh = km.reshape(bsz, m, XA_HEADS, XA_HEAD_DIM)
    vh = vm.reshape(bsz, m, XA_HEADS, XA_HEAD_DIM)
    scores = jnp.einsum("bshd,bmhd->bhsm", qh, kh).astype(jnp.float32) * (XA_HEAD_DIM ** -0.5)
    p = jax.nn.softmax(scores, axis=-1).astype(vh.dtype)
    o = jnp.einsum("bhsm,bmhd->bshd", p, vh)
    return o.reshape(bsz, s, XA_WIDTH)


def setup_inputs(seed: int = 0) -> dict:
    key = jax.random.key(seed)
    ks = jax.random.split(key, 20)
    f32 = jnp.float32
    nrm = lambda k, shape, scale: jax.random.normal(k, shape, f32) * scale
    x = jax.random.normal(ks[0], (BATCH, SEQ, D_MODEL), f32)
    mem = jax.random.normal(ks[1], (BATCH, MEM_LEN, D_MODEL), f32)
    norm_g = 1.0 + nrm(ks[2], (DEPTH, D_MODEL), 0.02)
    mem_norm_g = 1.0 + nrm(ks[3], (DEPTH, D_MODEL), 0.02)
    w_in = nrm(ks[4], (DEPTH, D_MODEL, IN_WIDTH), D_MODEL ** -0.5)
    conv_w = nrm(ks[5], (DEPTH, CONV_WIDTH, LRU_WIDTH), CONV_WIDTH ** -0.5)
    conv_b = nrm(ks[6], (DEPTH, LRU_WIDTH), 0.02)
    lru_w_a = nrm(ks[7], (DEPTH, LRU_HEADS, LRU_HEAD_DIM, LRU_HEAD_DIM), LRU_HEAD_DIM ** -0.5)
    lru_b_a = nrm(ks[8], (DEPTH, LRU_HEADS, LRU_HEAD_DIM), 0.02)
    lru_w_i = nrm(ks[9], (DEPTH, LRU_HEADS, LRU_HEAD_DIM, LRU_HEAD_DIM), LRU_HEAD_DIM ** -0.5)
    lru_b_i = nrm(ks[10], (DEPTH, LRU_HEADS, LRU_HEAD_DIM), 0.02)
    a_c = jax.random.uniform(ks[11], (DEPTH, LRU_WIDTH), f32, 0.9, 0.999)
    a0 = a_c ** (1.0 / LRU_C)
    lru_lambda = jnp.log(a0) - jnp.log1p(-a0)
    gla_w_g2 = nrm(ks[12], (DEPTH, GLA_RANK, GLA_K_WIDTH), GLA_RANK ** -0.5)
    gla_b_g = nrm(ks[13], (DEPTH, GLA_K_WIDTH), 0.02)
    gla_norm_g = 1.0 + nrm(ks[14], (DEPTH, GLA_V_WIDTH), 0.02)
    w_mem_kv = nrm(ks[15], (DEPTH, D_MODEL, 2 * XA_WIDTH), D_MODEL ** -0.5)
    w_out = nrm(ks[16], (DEPTH, MIX_WIDTH, D_MODEL), MIX_WIDTH ** -0.5)
    final_norm_g = 1.0 + nrm(ks[17], (D_MODEL,), 0.02)
    return {"x": x, "mem": mem, "norm_g": norm_g, "mem_norm_g": mem_norm_g, "w_in": w_in,
            "conv_w": conv_w, "conv_b": conv_b, "lru_w_a": lru_w_a, "lru_b_a": lru_b_a,
            "lru_w_i": lru_w_i, "lru_b_i": lru_b_i, "lru_lambda": lru_lambda,
            "gla_w_g2": gla_w_g2, "gla_b_g": gla_b_g, "gla_norm_g": gla_norm_g,
            "w_mem_kv": w_mem_kv, "w_out": w_out, "final_norm_g": final_norm_g}


def reference(x, mem, norm_g, mem_norm_g, w_in, conv_w, conv_b, lru_w_a, lru_b_a, lru_w_i,
              lru_b_i, lru_lambda, gla_w_g2, gla_b_g, gla_norm_g, w_mem_kv, w_out, final_norm_g):
    split_points = [int(v) for v in np.cumsum(IN_SIZES)[:-1]]
    for l in range(DEPTH):
        h = rms_norm(x, norm_g[l])
        proj = h @ w_in[l]
        u_lru, q_gla, k_gla, v_gla, g_lr, q_xa, gate = jnp.split(proj, split_points, axis=-1)
        u = causal_depthwise_conv(u_lru, conv_w[l], conv_b[l])
        y_lru = rg_lru(u, lru_w_a[l], lru_b_a[l], lru_w_i[l], lru_b_i[l], lru_lambda[l])
        y_gla = gla(q_gla, k_gla, v_gla, g_lr, gla_w_g2[l], gla_b_g[l], gla_norm_g[l])
        mem_n = rms_norm(mem, mem_norm_g[l])
        y_xa = memory_cross_attention(q_xa, mem_n, w_mem_kv[l])
        y = jnp.concatenate([y_lru, y_gla, y_xa], axis=-1) * jax.nn.silu(gate)
        x = x + y @ w_out[l]
    return rms_norm(x, final_norm_g)
```

```cpp
#include <hip/hip_runtime.h>
#include <stdint.h>

namespace {
constexpr int NB = 8, S = 4096, D = 1024, M = NB * S, MEM = 256, MM = NB * MEM;
constexpr int INW = 4624, NP = 4608, MIXW = 2048;
constexpr float EPS = 1e-6f;
constexpr int PC_U = 0, PC_Q = 1024, PC_K = 1280, PC_V = 1536, PC_XQ = 2048, PC_G = 2560;

typedef unsigned short bf16;
typedef short bf16x8 __attribute__((ext_vector_type(8)));
typedef float f32x4 __attribute__((ext_vector_type(4)));

constexpr size_t MiB = 1u << 20;
constexpr size_t WS_WIN = 1 * MiB, WS_WOUT = 10 * MiB, WS_WKV = 14 * MiB, WS_WG = 16 * MiB, WS_GLR = 17 * MiB, WS_MEMN = 19 * MiB, WS_KVM = 23 * MiB;
constexpr size_t WS_A = 48 * MiB  , WS_PROJ = 176 * MiB, WS_END = 464 * MiB;

__device__ __forceinline__ unsigned f2bf(float f) { unsigned u = __builtin_bit_cast(unsigned, f); return (u + 0x7fffu + ((u >> 16) & 1u)) >> 16; }
__device__ __forceinline__ float bf2f(bf16 h) { return __builtin_bit_cast(float, (unsigned)h << 16); }
__device__ __forceinline__ float wave_sum(float v) {
#pragma unroll
    for (int o = 1; o < 64; o <<= 1) v += __shfl_xor(v, o);
    return v;
}
__device__ __forceinline__ float sigmoidf_(float x) { return 1.f / (1.f + __expf(-x)); }

__global__ void k_prep_win(const float* __restrict__ w_in, bf16* __restrict__ WinT) {
    const size_t idx = (size_t)blockIdx.x * blockDim.x + threadIdx.x;
    if (idx >= (size_t)NP * D) return;
    const int n = (int)(idx / D), k = (int)(idx % D);
    const int col = n < 2048 ? n : n + 16;
    WinT[idx] = (bf16)f2bf(w_in[(size_t)k * INW + col]);
}
__global__ void k_prep_t(const float* __restrict__ w, bf16* __restrict__ WT, int K, int N) {
    const size_t idx = (size_t)blockIdx.x * blockDim.x + threadIdx.x;
    if (idx >= (size_t)N * K) return;
    const int n = (int)(idx / K), k = (int)(idx % K);
    WT[idx] = (bf16)f2bf(w[(size_t)k * N + n]);
}

template <bool GLRF>
__global__ void __launch_bounds__(256) k_rms_rows(const float* __restrict__ x, const float* __restrict__ g, bf16* __restrict__ H, int rows,
                                                   const float* __restrict__ w_in, float* __restrict__ GLR) {
    const int wave = threadIdx.x >> 6, lane = threadIdx.x & 63;
    const int row = blockIdx.x * 4 + wave;
    if (row >= rows) return;
    const float* xr = x + (size_t)row * D;
    float v[16]; float s = 0.f;
#pragma unroll
    for (int j = 0; j < 16; ++j) { v[j] = xr[lane + 64 * j]; s += v[j] * v[j]; }
    s = wave_sum(s);
    const float rstd = 1.0f / sqrtf(s * (1.0f / D) + EPS);
#pragma unroll
    for (int j = 0; j < 16; ++j) { v[j] = v[j] * rstd * g[lane + 64 * j]; H[(size_t)row * D + lane + 64 * j] = (bf16)f2bf(v[j]); }
    if (GLRF) {
        for (int c = 0; c < 16; ++c) {
            float a = 0.f;
#pragma unroll
            for (int j = 0; j < 16; ++j) a += v[j] * w_in[(size_t)(lane + 64 * j) * INW + 2048 + c];
            a = wave_sum(a);
            if (lane == 0) GLR[(size_t)row * 16 + c] = a;
        }
    }
}

template <int MODE>
__global__ void __launch_bounds__(256) k_gemm(const bf16* __restrict__ A, const bf16* __restrict__ Bt, int K, int ldo, bf16* __restrict__ Ob, float* __restrict__ Of, const float* __restrict__ X) {
    const int wave = threadIdx.x >> 6, lane = threadIdx.x & 63, wr = wave >> 1, wc = wave & 1;
    const int m0 = blockIdx.y * 64 + wr * 32, n0 = blockIdx.x * 64 + wc * 32;
    const int fr = lane & 15, fq = lane >> 4;
    f32x4 acc[2][2];
#pragma unroll
    for (int i = 0; i < 2; ++i)
#pragma unroll
        for (int j = 0; j < 2; ++j) acc[i][j] = (f32x4){0.f, 0.f, 0.f, 0.f};
    for (int k0 = 0; k0 < K; k0 += 32) {
        bf16x8 a[2], b[2];
#pragma unroll
        for (int i = 0; i < 2; ++i) a[i] = *(const bf16x8*)(A + (size_t)(m0 + 16 * i + fr) * K + k0 + 8 * fq);
#pragma unroll
        for (int j = 0; j < 2; ++j) b[j] = *(const bf16x8*)(Bt + (size_t)(n0 + 16 * j + fr) * K + k0 + 8 * fq);
#pragma unroll
        for (int i = 0; i < 2; ++i)
#pragma unroll
            for (int j = 0; j < 2; ++j) acc[i][j] = __builtin_amdgcn_mfma_f32_16x16x32_bf16(a[i], b[j], acc[i][j], 0, 0, 0);
    }
#pragma unroll
    for (int i = 0; i < 2; ++i)
#pragma unroll
        for (int j = 0; j < 2; ++j)
#pragma unroll
            for (int r = 0; r < 4; ++r) {
                const int row = m0 + 16 * i + 4 * fq + r, col = n0 + 16 * j + fr;
                float v = acc[i][j][r];
                if (MODE == 0) { if (col >= PC_G) v = v * sigmoidf_(v); Ob[(size_t)row * ldo + col] = (bf16)f2bf(v); }
                else if (MODE == 1) { Ob[(size_t)row * ldo + col] = (bf16)f2bf(v); }
                else { Of[(size_t)row * ldo + col] = X[(size_t)row * ldo + col] + v; }
            }
}

__global__ void __launch_bounds__(256) k_lru(const bf16* __restrict__ PROJ, const float* __restrict__ conv_w, const float* __restrict__ conv_b,
                                             const float* __restrict__ w_a, const float* __restrict__ b_a, const float* __restrict__ w_i, const float* __restrict__ b_i,
                                             const float* __restrict__ lam, bf16* __restrict__ Y) {
    __shared__ float su[128];
    __shared__ float sg[256];
    const int b = blockIdx.x >> 3, h = blockIdx.x & 7, j = threadIdx.x, c = j & 127;
    const float* W = (j < 128 ? w_a : w_i) + (size_t)h * 128 * 128;
    float w[128];
#pragma unroll
    for (int i = 0; i < 128; ++i) w[i] = W[i * 128 + c];
    const float bias = (j < 128 ? b_a : b_i)[h * 128 + c];
    const int ch = h * 128 + c;
    const float cw0 = conv_w[0 * D + ch], cw1 = conv_w[1 * D + ch], cw2 = conv_w[2 * D + ch], cw3 = conv_w[3 * D + ch], cb = conv_b[ch];
    const float l = lam[ch];
    const float sp = (-l > 20.f) ? -l : log1pf(__expf(-l));
    float x0 = 0.f, x1 = 0.f, x2 = 0.f, hstate = 0.f;
    for (int t = 0; t < S; ++t) {
        const size_t row = (size_t)b * S + t;
        float u = 0.f;
        if (j < 128) {
            const float x3 = bf2f(PROJ[row * NP + PC_U + ch]);
            u = cw0 * x0 + cw1 * x1 + cw2 * x2 + cw3 * x3 + cb;
            x0 = x1; x1 = x2; x2 = x3;
            su[c] = u;
        }
        __syncthreads();
        float a = bias;
#pragma unroll
        for (int i = 0; i < 128; ++i) a += su[i] * w[i];
        sg[j] = sigmoidf_(a);
        __syncthreads();
        if (j < 128) {
            const float r = sg[c], ig = sg[128 + c];
            const float log_a = -8.0f * r * sp;
            const float av = __expf(log_a);
            const float mult = sqrtf(fmaxf(0.f, -expm1f(2.0f * log_a)));
            hstate = av * hstate + mult * (ig * u);
            const float gate = bf2f(PROJ[row * NP + PC_G + ch]);
            Y[row * MIXW + ch] = (bf16)f2bf(hstate * gate);
        }
    }
}

constexpr int GLA_LDS = (64 * 64 * 3 + 64 * 128 * 2 + 64) * 4;
__global__ void __launch_bounds__(256) k_gla(const bf16* __restrict__ PROJ, const float* __restrict__ GLR, const float* __restrict__ w_g2, const float* __restrict__ b_g,
                                             const float* __restrict__ norm_g, bf16* __restrict__ Y) {
    extern __shared__ float sm[];
    float* qd = sm;
    float* kd = qd + 64 * 64;
    float* att = kd + 64 * 64;
    float* vv = att + 64 * 64;
    float* St = vv + 64 * 128;
    float* dec = St + 64 * 128;
    const int b = blockIdx.x >> 2, h = blockIdx.x & 3, tid = threadIdx.x;
    for (int i = tid; i < 64 * 128; i += 256) St[i] = 0.f;
    __syncthreads();
    for (int n = 0; n < S / 64; ++n) {
        const size_t row0 = (size_t)b * S + (size_t)n * 64;
        if (tid < 64) {
            const int k = tid; float wg[16];
#pragma unroll
            for (int r = 0; r < 16; ++r) wg[r] = w_g2[r * 256 + h * 64 + k];
            const float bg = b_g[h * 64 + k];
            float cum = 0.f;
            for (int t = 0; t < 64; ++t) {
                float logit = bg;
#pragma unroll
                for (int r = 0; r < 16; ++r) logit += GLR[(row0 + t) * 16 + r] * wg[r];
                const float ls = (logit < -20.f) ? logit : -log1pf(__expf(-logit));
                cum += ls * (1.0f / 16.0f);
                const float q = bf2f(PROJ[(row0 + t) * NP + PC_Q + h * 64 + k]) * 0.125f;
                const float kk = bf2f(PROJ[(row0 + t) * NP + PC_K + h * 64 + k]);
                qd[t * 64 + k] = q * __expf(cum);
                kd[t * 64 + k] = kk * __expf(-cum);
            }
            dec[k] = __expf(cum);
        }
        for (int i = tid; i < 64 * 128; i += 256) { const int t = i >> 7, v = i & 127; vv[i] = bf2f(PROJ[(row0 + t) * NP + PC_V + h * 128 + v]); }
        __syncthreads();
        for (int e = tid; e < 64 * 64; e += 256) {
            const int i = e >> 6, j = e & 63; float a = 0.f;
            if (j <= i) { for (int k = 0; k < 64; ++k) a += qd[i * 64 + k] * kd[j * 64 + k]; }
            att[e] = a;
        }
        __syncthreads();
        {
            const int i = tid >> 2, v0 = (tid & 3) * 32;
            float o[32];
#pragma unroll
            for (int v = 0; v < 32; ++v) o[v] = 0.f;
            for (int j = 0; j <= i; ++j) { const float a = att[i * 64 + j];
#pragma unroll
                for (int v = 0; v < 32; ++v) o[v] += a * vv[j * 128 + v0 + v]; }
            for (int k = 0; k < 64; ++k) { const float a = qd[i * 64 + k];
#pragma unroll
                for (int v = 0; v < 32; ++v) o[v] += a * St[k * 128 + v0 + v]; }
            float ss = 0.f;
#pragma unroll
            for (int v = 0; v < 32; ++v) ss += o[v] * o[v];
            ss += __shfl_xor(ss, 1); ss += __shfl_xor(ss, 2);
            const float rstd = 1.0f / sqrtf(ss * (1.0f / 128.0f) + EPS);
#pragma unroll
            for (int v = 0; v < 32; ++v) {
                const float y = o[v] * rstd * norm_g[h * 128 + v0 + v];
                const float gate = bf2f(PROJ[(row0 + i) * NP + PC_G + 1024 + h * 128 + v0 + v]);
                Y[(row0 + i) * MIXW + 1024 + h * 128 + v0 + v] = (bf16)f2bf(y * gate);
            }
        }
        __syncthreads();
        {
            const int k = tid >> 2, v0 = (tid & 3) * 32;
            float kv[32];
#pragma unroll
            for (int v = 0; v < 32; ++v) kv[v] = 0.f;
            for (int j = 0; j < 64; ++j) { const float a = kd[j * 64 + k];
#pragma unroll
                for (int v = 0; v < 32; ++v) kv[v] += a * vv[j * 128 + v0 + v]; }
            const float d = dec[k];
#pragma unroll
            for (int v = 0; v < 32; ++v) St[k * 128 + v0 + v] = d * (St[k * 128 + v0 + v] + kv[v]);
        }
        __syncthreads();
    }
}

__global__ void __launch_bounds__(256) k_xa(const bf16* __restrict__ PROJ, const bf16* __restrict__ KVM, bf16* __restrict__ Y) {
    __shared__ float sq[128];
    __shared__ float sp[256];
    __shared__ float red[8];
    __shared__ float so[2][128];
    const size_t row = blockIdx.x; const int b = (int)(row / S), tid = threadIdx.x, lane = tid & 63, wave = tid >> 6;
    for (int h = 0; h < 4; ++h) {
        if (tid < 128) sq[tid] = bf2f(PROJ[row * NP + PC_XQ + h * 128 + tid]);
        __syncthreads();
        const bf16* kr = KVM + ((size_t)b * MEM + tid) * 1024 + h * 128;
        float s = 0.f;
        for (int d = 0; d < 128; ++d) s += sq[d] * bf2f(kr[d]);
        s *= 0.08838834764831845f;
        float mx = s;
#pragma unroll
        for (int o = 1; o < 64; o <<= 1) mx = fmaxf(mx, __shfl_xor(mx, o));
        if (lane == 0) red[wave] = mx;
        __syncthreads();
        mx = fmaxf(fmaxf(red[0], red[1]), fmaxf(red[2], red[3]));
        const float p = __expf(s - mx);
        float sum = wave_sum(p);
        if (lane == 0) red[4 + wave] = sum;
        sp[tid] = p;
        __syncthreads();
        sum = red[4] + red[5] + red[6] + red[7];
        const int d = tid & 127, half = tid >> 7;
        float o = 0.f;
        for (int j = half * 128; j < half * 128 + 128; ++j) o += sp[j] * bf2f(KVM[((size_t)b * MEM + j) * 1024 + 512 + h * 128 + d]);
        so[half][d] = o;
        __syncthreads();
        if (tid < 128) {
            const float y = (so[0][tid] + so[1][tid]) / sum;
            const float gate = bf2f(PROJ[row * NP + PC_G + 1536 + h * 128 + tid]);
            Y[row * MIXW + 1536 + h * 128 + tid] = (bf16)f2bf(y * gate);
        }
        __syncthreads();
    }
}

__global__ void __launch_bounds__(256) k_final(float* __restrict__ out, const float* __restrict__ g) {
    const int wave = threadIdx.x >> 6, lane = threadIdx.x & 63;
    const int row = blockIdx.x * 4 + wave;
    float* xr = out + (size_t)row * D;
    float v[16]; float s = 0.f;
#pragma unroll
    for (int j = 0; j < 16; ++j) { v[j] = xr[lane + 64 * j]; s += v[j] * v[j]; }
    s = wave_sum(s);
    const float rstd = 1.0f / sqrtf(s * (1.0f / D) + EPS);
#pragma unroll
    for (int j = 0; j < 16; ++j) xr[lane + 64 * j] = v[j] * rstd * g[lane + 64 * j];
}
}

extern "C" void kernel_launch(void* const* d_in, const int* in_sizes, int n_in, void* d_out, int out_size, void* d_ws, size_t ws_size, hipStream_t stream) {
    const float* x = (const float*)d_in[0]; const float* mem = (const float*)d_in[1]; const float* norm_g = (const float*)d_in[2]; const float* mem_norm_g = (const float*)d_in[3];
    const float* w_in = (const float*)d_in[4]; const float* conv_w = (const float*)d_in[5]; const float* conv_b = (const float*)d_in[6];
    const float* w_a = (const float*)d_in[7]; const float* b_a = (const float*)d_in[8]; const float* w_i = (const float*)d_in[9]; const float* b_i = (const float*)d_in[10];
    const float* lam = (const float*)d_in[11]; const float* w_g2 = (const float*)d_in[12]; const float* b_g = (const float*)d_in[13]; const float* gla_norm_g = (const float*)d_in[14];
    const float* w_mem_kv = (const float*)d_in[15]; const float* w_out = (const float*)d_in[16]; const float* final_g = (const float*)d_in[17];
    float* out = (float*)d_out; unsigned char* ws = (unsigned char*)d_ws;
    if (ws_size < WS_END) return;
    bf16* WinT = (bf16*)(ws + WS_WIN); bf16* WoutT = (bf16*)(ws + WS_WOUT); bf16* WkvT = (bf16*)(ws + WS_WKV);
    float* GLR = (float*)(ws + WS_GLR); bf16* MEMN = (bf16*)(ws + WS_MEMN); bf16* KVM = (bf16*)(ws + WS_KVM);
    bf16* H = (bf16*)(ws + WS_A); bf16* Y = (bf16*)(ws + WS_A); bf16* PROJ = (bf16*)(ws + WS_PROJ);
    static bool attr = false;
    if (!attr) { hipFuncSetAttribute((const void*)k_gla, hipFuncAttributeMaxDynamicSharedMemorySize, GLA_LDS); attr = true; }

    k_prep_win<<<(NP * D + 255) / 256, 256, 0, stream>>>(w_in, WinT);
    k_prep_t<<<(MIXW * D + 255) / 256, 256, 0, stream>>>(w_out, WoutT, MIXW, D);
    k_prep_t<<<(D * D + 255) / 256, 256, 0, stream>>>(w_mem_kv, WkvT, D, D);
    k_rms_rows<true><<<M / 4, 256, 0, stream>>>(x, norm_g, H, M, w_in, GLR);
    k_rms_rows<false><<<MM / 4, 256, 0, stream>>>(mem, mem_norm_g, MEMN, MM, nullptr, nullptr);
    k_gemm<0><<<dim3(NP / 64, M / 64), 256, 0, stream>>>(H, WinT, D, NP, PROJ, nullptr, nullptr);
    k_gemm<1><<<dim3(D / 64, MM / 64), 256, 0, stream>>>(MEMN, WkvT, D, D, KVM, nullptr, nullptr);
    k_lru<<<NB * 8, 256, 0, stream>>>(PROJ, conv_w, conv_b, w_a, b_a, w_i, b_i, lam, Y);
    k_gla<<<NB * 4, 256, GLA_LDS, stream>>>(PROJ, GLR, w_g2, b_g, gla_norm_g, Y);
    k_xa<<<M, 256, 0, stream>>>(PROJ, KVM, Y);
    k_gemm<2><<<dim3(D / 64, M / 64), 256, 0, stream>>>(Y, WoutT, MIXW, D, nullptr, out, x);
    k_final<<<M / 4, 256, 0, stream>>>(out, final_g);
}
```

```cpp
#include <hip/hip_runtime.h>
#include <cstdio>
#include <cstdint>

constexpr int NB = 8, SEQ = 4096, D = 1024, M = NB * SEQ, MEM = 256, MM = NB * MEM;
constexpr int INW = 4624, NP = 4608, MIXW = 2048;
constexpr float EPS = 1e-6f;
constexpr int PC_U = 0, PC_Q = 1024, PC_K = 1280, PC_V = 1536, PC_XQ = 2048, PC_G = 2560;
constexpr float LOG2E = 1.4426950408889634f;

constexpr size_t MiB = 1u << 20;
constexpr size_t WS_CTL = 0, CTL_ZERO_BYTES = 128 * 1024;
constexpr size_t WS_WIN = 1 * MiB;
constexpr size_t WS_WOUT = 10 * MiB;
constexpr size_t WS_WKV = 14 * MiB;
constexpr size_t WS_WG = 16 * MiB;
constexpr size_t WS_GLR = 17 * MiB;
constexpr size_t WS_MEMN = 19 * MiB;
constexpr size_t WS_KVM = 23 * MiB;
constexpr size_t WS_RSTD = 27 * MiB;
constexpr size_t WS_LAGG = 28 * MiB;
constexpr size_t WS_XCH = 30 * MiB;
constexpr size_t WS_GAGG = 32 * MiB;
constexpr size_t WS_A = 48 * MiB;
constexpr size_t WS_PROJ = 176 * MiB;
constexpr size_t WS_END = 464 * MiB;
namespace pg8 {
#define PG8_LAS __attribute__((address_space(3)))
typedef unsigned short bf16_t;
typedef short bf16x8 __attribute__((ext_vector_type(8)));
typedef float f32x4 __attribute__((ext_vector_type(4)));
typedef unsigned u32x4 __attribute__((ext_vector_type(4)));
constexpr int BM = 256, BK = 64, HALF = 128, HTB = HALF * BK * 2  , STAGE_BYTES = 8 * HTB, NXCD = 8, WGM = 8;

__host__ __device__ __forceinline__ int lds_byte(int r, int c) { const int st = (r >> 4) * 2 + (c >> 5), rr = r & 15, cc = c & 31, ob = rr * 64 + cc * 2; return st * 1024 + (ob ^ (((ob >> 9) & 1) << 5)); }
__host__ __device__ __forceinline__ void stage_rc(int b, int& R, int& C) { const int st = b / 1024, sb = b % 1024, swz = sb ^ (((sb >> 9) & 1) << 5); R = (st >> 1) * 16 + swz / 64; C = (st & 1) * 32 + (swz % 64) / 2; }
__host__ __device__ __forceinline__ int perm32(int rho) { const int n = rho >> 4, i = rho & 15; return 8 * (i >> 2) + 4 * n + (i & 3); }

struct Unit { int pm, pn; };
struct Gemm { const bf16_t* A; const bf16_t* Bt; int M, N, K; };

struct StaticOrder {
    int nM, nN, nwg, G, c;
    __host__ __device__ void init(int M, int N, int G_, int c_) { nM = M / BM; nN = N / BM; nwg = nM * nN; G = G_; c = c_; }
    __host__ __device__ bool next(int i, Unit& u) const {
        const long L = (long)i * G + c; if (L >= nwg) return false;
        int wgid = (int)L; { const int q = nwg / NXCD, r = nwg % NXCD, xcd = wgid % NXCD, off = wgid / NXCD; wgid = (xcd < r ? xcd * (q + 1) : r * (q + 1) + (xcd - r) * q) + off; }
        const int nig = WGM * nN, gid = wgid / nig, fm = gid * WGM, gsz = (nM - fm) < WGM ? (nM - fm) : WGM;
        u.pm = fm + ((wgid % nig) % gsz); u.pn = (wgid % nig) / gsz; return true;
    }
    __device__ __forceinline__ void a_ready(const Unit&) const {}
    __device__ __forceinline__ void done(const Unit&) const {}
};

__device__ __forceinline__ unsigned cvt_pk_bf16(float lo, float hi) { unsigned r; asm volatile("v_cvt_pk_bf16_f32 %0, %1, %2" : "=v"(r) : "v"(lo), "v"(hi)); return r; }
__device__ __forceinline__ float silu_f(float v) { return v * __builtin_amdgcn_rcpf(1.0f + __builtin_amdgcn_exp2f(-1.4426950408889634f * v)); }

struct EpiProj {
    static constexpr bool PERM = true, AFTER_DRAIN = false;
    bf16_t* O; int ldc; const float* rstd; int gate_pn;
    __device__ __forceinline__ void operator()(const f32x4 (&acc)[2][2][4][2], const Unit& u, int wr, int wc, int fr, int fq) const {
        const int row0 = u.pm * BM + wr * 64 + fr, col0 = u.pn * BM + wc * 32 + 8 * fq;
        const bool act = u.pn >= gate_pn;
#pragma unroll
        for (int ai = 0; ai < 2; ++ai)
#pragma unroll
            for (int m = 0; m < 4; ++m) { const int row = row0 + ai * HALF + m * 16; const float rs = rstd ? rstd[row] : 1.0f; bf16_t* rowp = O + (size_t)row * ldc + col0;
#pragma unroll
                for (int bj = 0; bj < 2; ++bj) { f32x4 v0 = acc[ai][bj][m][0] * rs, v1 = acc[ai][bj][m][1] * rs;
                    if (act) { v0 = (f32x4){silu_f(v0[0]), silu_f(v0[1]), silu_f(v0[2]), silu_f(v0[3])}; v1 = (f32x4){silu_f(v1[0]), silu_f(v1[1]), silu_f(v1[2]), silu_f(v1[3])}; }
                    u32x4 w; w.x = cvt_pk_bf16(v0[0], v0[1]); w.y = cvt_pk_bf16(v0[2], v0[3]); w.z = cvt_pk_bf16(v1[0], v1[1]); w.w = cvt_pk_bf16(v1[2], v1[3]);
                    *(u32x4*)(rowp + bj * HALF) = w; } }
    }
};
struct EpiRes {
    static constexpr bool PERM = false, AFTER_DRAIN = false;
    const float* base; float* out; int ldc;
    __device__ __forceinline__ void operator()(const f32x4 (&acc)[2][2][4][2], const Unit& u, int wr, int wc, int fr, int fq) const {
        const int col0 = u.pn * BM + wc * 32 + 4 * fq;
#pragma unroll
        for (int ai = 0; ai < 2; ++ai)
#pragma unroll
            for (int m = 0; m < 4; ++m) { const size_t off = (size_t)(u.pm * BM + ai * HALF + wr * 64 + m * 16 + fr) * ldc + col0;
#pragma unroll
                for (int bj = 0; bj < 2; ++bj)
#pragma unroll
                    for (int n = 0; n < 2; ++n) { const f32x4 bs = *(const f32x4*)(base + off + bj * HALF + n * 16); *(f32x4*)(out + off + bj * HALF + n * 16) = bs + acc[ai][bj][m][n]; } }
    }
};
template <class Epi, class Sched, bool ALIGN_EPI = false, bool SP2 = false>
__device__ __forceinline__ void gemm_phase(PG8_LAS unsigned char* lds, const Gemm g, const Sched& S, const Epi& E) {
    const int tid = threadIdx.x, wid = __builtin_amdgcn_readfirstlane(tid >> 6), lane = tid & 63, wr = wid >> 2, wc = wid & 3, fr = lane & 15, fq = lane >> 4;
    const int K = g.K, nt = K / BK;
    unsigned voffA[2], voffB[2];
#pragma unroll
    for (int i = 0; i < 2; ++i) { int R, C; stage_rc(tid * 16 + i * 8192, R, C); const int Rb = Epi::PERM ? ((R & ~31) + perm32(R & 31)) : R;
        voffA[i] = (unsigned)(R * K + C) * 2u; voffB[i] = (unsigned)(Rb * K + C) * 2u; }
    const size_t kstep = (size_t)(BK * 2);
    const size_t hstep = (size_t)HALF * K * 2;
    const size_t tstep = 2 * hstep;
    const unsigned ldsw = (unsigned)wid * 1024u;
    const int aoff = lds_byte(wr * 64 + fr, fq * 8), boff = lds_byte(wc * 32 + fr, fq * 8);
#define PG8_SA(b, h) (((b) * 2 + (h)) * HTB)
#define PG8_SB(b, h) ((4 + (b) * 2 + (h)) * HTB)
#define PG8_STAGE(bufoff, gbase, voff) do { _Pragma("unroll") for (int _i = 0; _i < 2; ++_i) \
        __builtin_amdgcn_global_load_lds((const unsigned*)((const char*)(gbase) + (voff)[_i]), (PG8_LAS unsigned*)(lds + (bufoff) + ldsw + _i * 8192), 16, 0, 0); } while (0)
#define PG8_LDA(dst, b, h) do { _Pragma("unroll") for (int m = 0; m < 4; ++m) _Pragma("unroll") for (int k = 0; k < 2; ++k) dst[m][k] = *(const PG8_LAS bf16x8*)(lds + PG8_SA(b, h) + aoff + m * 2048 + k * 1024); } while (0)
#define PG8_LDB(dst, b, h) do { _Pragma("unroll") for (int n = 0; n < 2; ++n) _Pragma("unroll") for (int k = 0; k < 2; ++k) dst[n][k] = *(const PG8_LAS bf16x8*)(lds + PG8_SB(b, h) + boff + n * 2048 + k * 1024); } while (0)
#define PG8_MMA(ai, bj, At, Bt) do { __builtin_amdgcn_s_setprio(1); _Pragma("unroll") for (int m = 0; m < 4; ++m) _Pragma("unroll") for (int n = 0; n < 2; ++n) _Pragma("unroll") for (int k = 0; k < 2; ++k) \
        acc[ai][bj][m][n] = __builtin_amdgcn_mfma_f32_16x16x32_bf16(Bt[n][k], At[m][k], acc[ai][bj][m][n], 0, 0, 0); __builtin_amdgcn_s_setprio(0); } while (0)
#define PG8_WAIT_V(n) asm volatile("s_waitcnt vmcnt(" #n ")" ::: "memory")
#define PG8_WAIT_L(n) asm volatile("s_waitcnt lgkmcnt(" #n ")" ::: "memory")
#define PG8_BAR __builtin_amdgcn_s_barrier()
#define PG8_SCHED __builtin_amdgcn_sched_barrier(0)
    Unit cur, nxt; int ui = 0;
    if (!S.next(0, cur)) return;
    f32x4 acc[2][2][4][2];
#pragma unroll
    for (int a = 0; a < 2; ++a)
#pragma unroll
        for (int b = 0; b < 2; ++b)
#pragma unroll
            for (int m = 0; m < 4; ++m)
#pragma unroll
                for (int n = 0; n < 2; ++n) acc[a][b][m][n] = (f32x4){0.f, 0.f, 0.f, 0.f};
    bf16x8 At[4][2], B0[2][2], B1[2][2];
    const char* cA = (const char*)g.A + (size_t)cur.pm * tstep; const char* cB = (const char*)g.Bt + (size_t)cur.pn * tstep;
    S.a_ready(cur);
    if constexpr (SP2) {
        PG8_STAGE(PG8_SB(0, 0), cB, voffB); PG8_STAGE(PG8_SB(0, 1), cB + hstep, voffB); PG8_STAGE(PG8_SA(0, 0), cA, voffA); PG8_STAGE(PG8_SA(0, 1), cA + hstep, voffA);
        if (wr == 1) PG8_BAR;
        PG8_WAIT_V(2); PG8_BAR;
        PG8_STAGE(PG8_SB(1, 0), cB + kstep, voffB); PG8_STAGE(PG8_SA(1, 0), cA + kstep, voffA); PG8_STAGE(PG8_SB(1, 1), cB + hstep + kstep, voffB);
        PG8_WAIT_V(6); PG8_BAR;
    } else {
        PG8_STAGE(PG8_SB(0, 0), cB, voffB); PG8_STAGE(PG8_SA(0, 0), cA, voffA); PG8_STAGE(PG8_SB(0, 1), cB + hstep, voffB); PG8_STAGE(PG8_SA(0, 1), cA + hstep, voffA);
        if (wr == 1) PG8_BAR;
        PG8_WAIT_V(4); PG8_BAR;
        PG8_STAGE(PG8_SB(1, 0), cB + kstep, voffB); PG8_STAGE(PG8_SA(1, 0), cA + kstep, voffA); PG8_STAGE(PG8_SB(1, 1), cB + hstep + kstep, voffB);
        PG8_WAIT_V(6); PG8_BAR;
    }
    for (;;) {
        const bool has_next = S.next(ui + 1, nxt);
        const char* nA = has_next ? (const char*)g.A + (size_t)nxt.pm * tstep : cA; const char* nB = has_next ? (const char*)g.Bt + (size_t)nxt.pn * tstep : cB;
        for (int t = 0; t < nt; t += 2) {
            const bool last = (t == nt - 2);
            const char* a1 = cA + (size_t)(t + 1) * kstep;
            const char* a2 = last ? nA : cA + (size_t)(t + 2) * kstep; const char* b2 = last ? nB : cB + (size_t)(t + 2) * kstep;
            const char* a3 = a2 + kstep; const char* b3 = b2 + kstep;
            if (last && has_next) S.a_ready(nxt);
            if constexpr (SP2) {
            PG8_LDB(B0, 0, 0); PG8_LDB(B1, 0, 1); PG8_SCHED; PG8_LDA(At, 0, 0); PG8_STAGE(PG8_SA(1, 1), a1 + hstep, voffA);
            PG8_WAIT_V(8); PG8_WAIT_L(0); PG8_BAR; PG8_MMA(0, 0, At, B0); PG8_MMA(0, 1, At, B1); PG8_BAR; PG8_SCHED;
            PG8_LDA(At, 0, 1); PG8_STAGE(PG8_SB(0, 0), b2, voffB); PG8_STAGE(PG8_SB(0, 1), b2 + hstep, voffB); PG8_STAGE(PG8_SA(0, 0), a2, voffA);
            PG8_WAIT_V(8); PG8_WAIT_L(0); PG8_BAR; PG8_MMA(1, 0, At, B0); PG8_MMA(1, 1, At, B1); PG8_BAR; PG8_SCHED;
            PG8_LDB(B0, 1, 0); PG8_LDB(B1, 1, 1); PG8_SCHED; PG8_LDA(At, 1, 0); PG8_STAGE(PG8_SA(0, 1), a2 + hstep, voffA);
            PG8_WAIT_V(8); PG8_WAIT_L(0); PG8_BAR; PG8_MMA(0, 0, At, B0); PG8_MMA(0, 1, At, B1); PG8_BAR; PG8_SCHED;
            PG8_LDA(At, 1, 1); PG8_STAGE(PG8_SB(1, 0), b3, voffB); PG8_STAGE(PG8_SB(1, 1), b3 + hstep, voffB); PG8_STAGE(PG8_SA(1, 0), a3, voffA);
            PG8_WAIT_V(8); PG8_WAIT_L(0); PG8_BAR; PG8_MMA(1, 0, At, B0); PG8_MMA(1, 1, At, B1); PG8_BAR; PG8_SCHED;
            } else {
            PG8_LDB(B0, 0, 0); PG8_SCHED; PG8_LDA(At, 0, 0); PG8_STAGE(PG8_SA(1, 1), a1 + hstep, voffA);
            PG8_WAIT_L(8); PG8_BAR; PG8_WAIT_L(0); PG8_MMA(0, 0, At, B0); PG8_BAR; PG8_SCHED;
            PG8_LDB(B1, 0, 1); PG8_STAGE(PG8_SB(0, 0), b2, voffB);
            PG8_BAR; PG8_WAIT_L(0); PG8_MMA(0, 1, At, B1); PG8_BAR;
            PG8_LDA(At, 0, 1); PG8_STAGE(PG8_SA(0, 0), a2, voffA);
            PG8_BAR; PG8_WAIT_L(0); PG8_MMA(1, 0, At, B0); PG8_BAR; PG8_SCHED;
            PG8_STAGE(PG8_SB(0, 1), b2 + hstep, voffB);
            PG8_WAIT_V(6); PG8_BAR; PG8_MMA(1, 1, At, B1); PG8_BAR;
            PG8_LDB(B0, 1, 0); PG8_SCHED; PG8_LDA(At, 1, 0); PG8_STAGE(PG8_SA(0, 1), a2 + hstep, voffA);
            PG8_WAIT_L(8); PG8_BAR; PG8_WAIT_L(0); PG8_MMA(0, 0, At, B0); PG8_BAR; PG8_SCHED;
            PG8_LDB(B1, 1, 1); PG8_STAGE(PG8_SB(1, 0), b3, voffB);
            PG8_BAR; PG8_WAIT_L(0); PG8_MMA(0, 1, At, B1); PG8_BAR;
            PG8_LDA(At, 1, 1); PG8_STAGE(PG8_SA(1, 0), a3, voffA);
            PG8_BAR; PG8_WAIT_L(0); PG8_MMA(1, 0, At, B0); PG8_BAR; PG8_SCHED;
            PG8_STAGE(PG8_SB(1, 1), b3 + hstep, voffB);
            PG8_WAIT_V(6); PG8_BAR; PG8_MMA(1, 1, At, B1); PG8_BAR;
            }
        }
        if constexpr (ALIGN_EPI) { if (wr == 0) PG8_BAR; }
        if constexpr (!Epi::AFTER_DRAIN) { E(acc, cur, wr, wc, fr, fq); S.done(cur); }
        if (!has_next) break;
#pragma unroll
        for (int a = 0; a < 2; ++a)
#pragma unroll
            for (int b = 0; b < 2; ++b)
#pragma unroll
                for (int m = 0; m < 4; ++m)
#pragma unroll
                    for (int n = 0; n < 2; ++n) acc[a][b][m][n] = (f32x4){0.f, 0.f, 0.f, 0.f};
        cur = nxt; cA = nA; cB = nB; ++ui;
        if constexpr (ALIGN_EPI) { if (wr == 1) PG8_BAR; }
    }
    PG8_WAIT_V(0);
    if constexpr (!ALIGN_EPI) { if (wr == 0) PG8_BAR; }
    PG8_BAR;
    if constexpr (Epi::AFTER_DRAIN) { E.fused(acc, cur, wr, wc, fr, fq, lds, wid, lane); S.done(cur); }
#undef PG8_SA
#undef PG8_SB
#undef PG8_STAGE
#undef PG8_LDA
#undef PG8_LDB
#undef PG8_MMA
#undef PG8_WAIT_V
#undef PG8_WAIT_L
#undef PG8_BAR
#undef PG8_SCHED
}
}
constexpr int NWAVES = 8;
constexpr int RING_OFF = 0, RING_BYTES = 131072;
constexpr int LDSCTL_OFF = RING_BYTES, MISC_OFF = LDSCTL_OFF + 320;
constexpr int LDS_BYTES = 147456;
#define GAS __attribute__((address_space(1)))
#define LAS __attribute__((address_space(3)))
typedef unsigned short bf16;
typedef unsigned v4u __attribute__((ext_vector_type(4)));
typedef unsigned v2u __attribute__((ext_vector_type(2)));
typedef float f32x4 __attribute__((ext_vector_type(4)));
typedef float f32x2 __attribute__((ext_vector_type(2)));
typedef short bf16x8 __attribute__((ext_vector_type(8)));
typedef short bf16x4 __attribute__((ext_vector_type(4)));
typedef GAS unsigned gu32;
typedef GAS unsigned long long gu64;
#define RLX_AGENT __ATOMIC_RELAXED, __HIP_MEMORY_SCOPE_AGENT
#define LDS_WAIT() asm volatile("s_waitcnt lgkmcnt(0)" ::: "memory")
#define VM_WAIT() asm volatile("s_waitcnt vmcnt(0)" ::: "memory")
__device__ __forceinline__ unsigned f2bf(float f) { unsigned u = __builtin_bit_cast(unsigned, f); return (u + 0x7fffu + ((u >> 16) & 1u)) >> 16; }
__device__ __forceinline__ unsigned pk2(float lo, float hi) { return f2bf(lo) | (f2bf(hi) << 16); }
__device__ __forceinline__ float bf2f(unsigned h) { return __builtin_bit_cast(float, h << 16); }
__device__ __forceinline__ float bflo(unsigned w) { return __builtin_bit_cast(float, w << 16); }
__device__ __forceinline__ float bfhi(unsigned w) { return __builtin_bit_cast(float, w & 0xffff0000u); }
__device__ __forceinline__ float wave_sum(float v) {
#pragma unroll
    for (int o = 1; o < 64; o <<= 1) v += __shfl_xor(v, o);
    return v;
}
__device__ __forceinline__ float ex2(float x) { return __builtin_amdgcn_exp2f(x); }
__device__ __forceinline__ float rcp(float x) { return __builtin_amdgcn_rcpf(x); }
constexpr int CW_TMO = 0, CW_CODE = 1, CW_BAR = 4096, CW_SEAM = 16384;
#define XB_TMO      128
#define XB_XCNT(j)  (256  + 64 * (j))
#define XB_XSUB(j)  (1280 + 64 * (j))
#define XB_XGEN(j)  (2304 + 64 * (j))
#define XB_TOP      3328
#define XB_TOPGEN   3392
#define XCD_BAR_WORDS 3456
#define XB_SPIN_CAP (1u << 18)

__device__ __forceinline__ unsigned xb_ld(unsigned* p)              { return __hip_atomic_load(p, __ATOMIC_RELAXED, __HIP_MEMORY_SCOPE_AGENT); }
__device__ __forceinline__ unsigned xb_add(unsigned* p, unsigned v) { return __hip_atomic_fetch_add(p, v, __ATOMIC_RELAXED, __HIP_MEMORY_SCOPE_AGENT); }
__device__ __forceinline__ unsigned xb_xcc_id() { return (unsigned)__builtin_amdgcn_s_getreg((3 << 11) | 20) & 0xFu; }
#define XB_SPIN(cond, bar) do { unsigned _sp = 0; while (cond) { __builtin_amdgcn_s_sleep(1); \
    if ((++_sp & 255u) == 0u) { if (xb_ld(&(bar)[XB_TMO])) break; if (_sp > XB_SPIN_CAP) { atomicAdd(&(bar)[XB_TMO], 1u); break; } } } } while (0)

struct XcdBarrier {
    unsigned* bar; unsigned x;
    volatile LAS unsigned* st;
};

__device__ __forceinline__ XcdBarrier xcd_barrier_post(unsigned* bar, volatile LAS unsigned* st) {
    XcdBarrier b; b.bar = bar; b.x = xb_xcc_id(); b.st = st;
    if (threadIdx.x == 0) (void)xb_add(&bar[XB_XCNT(b.x)], 1u);
    return b;
}
__device__ __forceinline__ void xcd_barrier_complete(unsigned* bar, unsigned x, unsigned& nloc, unsigned& nx) {
    const unsigned G = gridDim.x * gridDim.y * gridDim.z;
    unsigned sum, cnt, mine, sp = 0u;
    for (;;) {
        sum = 0u; cnt = 0u; mine = 0u;
#pragma unroll
        for (unsigned j = 0; j < 16; ++j) { const unsigned c = xb_ld(&bar[XB_XCNT(j)]); sum += c; cnt += (c > 0u) ? 1u : 0u; mine = (j == x) ? c : mine; }
        if (sum == G) break;
        __builtin_amdgcn_s_sleep(1);
        if ((++sp & 255u) == 0u) { if (xb_ld(&bar[XB_TMO])) break; if (sp > XB_SPIN_CAP) { atomicAdd(&bar[XB_TMO], 1u); break; } }
    }
    nloc = mine > 0u ? mine : 1u; nx = cnt > 0u ? cnt : 1u;
}

__device__ __forceinline__ void xcd_barrier(const XcdBarrier& b) {
    asm volatile("s_waitcnt vmcnt(0)" ::: "memory");
    __syncthreads();
    if (threadIdx.x == 0) {
        unsigned* bar = b.bar;
        __builtin_amdgcn_s_waitcnt(0);
        unsigned nloc = b.st[0], nx = b.st[1];
        if (nloc == 0u) { xcd_barrier_complete(bar, b.x, nloc, nx); b.st[0] = nloc; b.st[1] = nx; }
        const unsigned old = xb_add(&bar[XB_XSUB(b.x)], 1u);
        const unsigned gen = old / nloc;
        if (old + 1u == (gen + 1u) * nloc) {
            __builtin_amdgcn_fence(__ATOMIC_RELEASE, "agent");
            asm volatile("s_waitcnt vmcnt(0)" ::: "memory");
            const unsigned og = xb_add(&bar[XB_TOP], 1u);
            const unsigned tg = og / nx;
            if (og + 1u == (tg + 1u) * nx) xb_add(&bar[XB_TOPGEN], 1u);
            else XB_SPIN(xb_ld(&bar[XB_TOPGEN]) == tg, bar);
            __builtin_amdgcn_fence(__ATOMIC_ACQUIRE, "agent");
            xb_add(&bar[XB_XGEN(b.x)], 1u);
            asm volatile("s_waitcnt vmcnt(0)" ::: "memory");
        } else {
            XB_SPIN(xb_ld(&bar[XB_XGEN(b.x)]) == gen, bar);
            __builtin_amdgcn_fence(__ATOMIC_ACQUIRE, "agent");
            asm volatile("s_waitcnt vmcnt(0)" ::: "memory");
        }
    }
    __syncthreads();
}
struct Frame {
    LAS unsigned char* lds;
    volatile LAS unsigned* MISC;
    gu32* ctl;
    int tid, lane, wave, vcu, G;
    const float *x, *mem, *norm_g, *mem_norm_g, *w_in, *conv_w, *conv_b, *w_a, *b_a, *w_i, *b_i, *lam, *w_g2, *b_g, *gla_norm_g, *w_mem_kv, *w_out, *final_g;
    float* out;
    bf16 *WinT, *WoutT, *WkvT, *WgT, *MEMN, *KVM, *XG, *Y, *PROJ;
    float *GLR, *RSTD, *LAGG, *GAGG;
    unsigned char* ws;
};

__device__ __forceinline__ void p0_transpose_item(const float* W, int ldw, int ncols, bf16* WT, int Kt, int row_off, float scale, LAS float* scr, int item, int lane) {
    const int nblk = ncols / 32, kb = item / nblk, nb = item % nblk, k0 = 64 * kb, n0 = 32 * nb;
#pragma unroll 8
    for (int i = 0; i < 32; ++i) { const int kk = 2 * i + (lane >> 5); scr[kk * 33 + (lane & 31)] = W[(size_t)(k0 + kk) * ldw + n0 + (lane & 31)] * scale; }
    LDS_WAIT(); asm volatile("" ::: "memory");
    const int c = lane & 7;
#pragma unroll
    for (int j = 0; j < 4; ++j) { const int n = (lane >> 3) + 8 * j; const LAS float* s = scr + (8 * c) * 33 + n;
        v4u o; o.x = pk2(s[0 * 33], s[1 * 33]); o.y = pk2(s[2 * 33], s[3 * 33]); o.z = pk2(s[4 * 33], s[5 * 33]); o.w = pk2(s[6 * 33], s[7 * 33]);
        *(GAS v4u*)(WT + (size_t)(row_off + n0 + n) * Kt + k0 + 8 * c) = o; }
    LDS_WAIT(); asm volatile("" ::: "memory");
}
__device__ __forceinline__ void rms_row_to_bf16(int lane, const float* xrow, const float* g, bf16* orow) {
    const GAS f32x4* xr = (const GAS f32x4*)xrow + lane; const GAS f32x4* gr = (const GAS f32x4*)g + lane;
    f32x4 v[4]; float s = 0.f;
#pragma unroll
    for (int j = 0; j < 4; ++j) { v[j] = xr[64 * j]; s += (v[j].x * v[j].x + v[j].y * v[j].y) + (v[j].z * v[j].z + v[j].w * v[j].w); }
    const float rstd = 1.f / sqrtf(wave_sum(s) * (1.f / D) + EPS);
    GAS unsigned long long* o8 = (GAS unsigned long long*)orow + lane;
#pragma unroll
    for (int j = 0; j < 4; ++j) { const f32x4 gg = gr[64 * j]; o8[64 * j] = (unsigned long long)pk2(v[j].x * rstd * gg.x, v[j].y * rstd * gg.y) | ((unsigned long long)pk2(v[j].z * rstd * gg.z, v[j].w * rstd * gg.w) << 32); }
}
constexpr int WG1_STRIDE = 2064;
__device__ __forceinline__ void p0_rows16(Frame& F, int r0) {
    const int lane = F.lane, fr = lane & 15, fq = lane >> 4;
    const GAS f32x4* xr = (const GAS f32x4*)(F.x + (size_t)(r0 + fr) * D + 8 * fq);
    const GAS f32x4* gp = (const GAS f32x4*)(F.norm_g + 8 * fq);
    GAS v4u* hr = (GAS v4u*)(F.XG + (size_t)(r0 + fr) * D + 8 * fq);
    const LAS unsigned char* wg = F.lds + fr * WG1_STRIDE + 16 * fq;
    f32x4 acc = (f32x4){0.f, 0.f, 0.f, 0.f}; float ss = 0.f;
#pragma unroll 4
    for (int s = 0; s < 32; ++s) {
        const f32x4 a0 = xr[8 * s], a1 = xr[8 * s + 1], g0 = gp[8 * s], g1 = gp[8 * s + 1];
        ss += (a0.x * a0.x + a0.y * a0.y) + (a0.z * a0.z + a0.w * a0.w) + (a1.x * a1.x + a1.y * a1.y) + (a1.z * a1.z + a1.w * a1.w);
        const f32x4 v0 = a0 * g0, v1 = a1 * g1;
        v4u hi; hi.x = pk2(v0.x, v0.y); hi.y = pk2(v0.z, v0.w); hi.z = pk2(v1.x, v1.y); hi.w = pk2(v1.z, v1.w);
        v4u lo; lo.x = pk2(v0.x - bflo(hi.x), v0.y - bfhi(hi.x)); lo.y = pk2(v0.z - bflo(hi.y), v0.w - bfhi(hi.y)); lo.z = pk2(v1.x - bflo(hi.z), v1.y - bfhi(hi.z)); lo.w = pk2(v1.z - bflo(hi.w), v1.w - bfhi(hi.w));
        hr[4 * s] = hi;
        const bf16x8 wb = *(const LAS bf16x8*)(wg + 64 * s);
        acc = __builtin_amdgcn_mfma_f32_16x16x32_bf16(__builtin_bit_cast(bf16x8, hi), wb, acc, 0, 0, 0);
        acc = __builtin_amdgcn_mfma_f32_16x16x32_bf16(__builtin_bit_cast(bf16x8, lo), wb, acc, 0, 0, 0);
    }
    ss += __shfl_xor(ss, 16); ss += __shfl_xor(ss, 32);
    const float rstd = 1.f / sqrtf(ss * (1.f / D) + EPS);
    if (fq == 0) F.RSTD[r0 + fr] = rstd;
#pragma unroll
    for (int r = 0; r < 4; ++r) { const int row = 4 * fq + r; const float rs = __shfl(rstd, row); F.GLR[(size_t)(r0 + row) * 16 + fr] = acc[r] * rs; }
}
__device__ __forceinline__ void p0_prologue(Frame& F) {
    LAS float* scr = (LAS float*)(F.lds + RING_OFF + F.wave * 16384);
    const int gw = F.vcu * NWAVES + F.wave, NGW = F.G * NWAVES;
    constexpr int I_IN1 = (D / 64) * (2048 / 32), I_IN2 = (D / 64) * (2560 / 32), I_OUT = (MIXW / 64) * (D / 32), I_KV = (D / 64) * (D / 32), I_G = 16 * 8;
    constexpr int NITEMS = I_IN1 + I_IN2 + I_OUT + I_KV + I_G;
    for (int it = gw; it < NITEMS; it += NGW) {
        int r = it;
        if (r < I_IN1) { p0_transpose_item(F.w_in, INW, 2048, F.WinT, D, 0, 1.f, scr, r, F.lane); continue; } r -= I_IN1;
        if (r < I_IN2) { p0_transpose_item(F.w_in + 2064, INW, 2560, F.WinT, D, 2048, 1.f, scr, r, F.lane); continue; } r -= I_IN2;
        if (r < I_OUT) { p0_transpose_item(F.w_out, D, D, F.WoutT, MIXW, 0, 1.f, scr, r, F.lane); continue; } r -= I_OUT;
        if (r < I_KV) { p0_transpose_item(F.w_mem_kv, D, D, F.WkvT, D, 0, 1.f, scr, r, F.lane); continue; } r -= I_KV;
        { const int mat = r >> 3, h = mat >> 1, ri = mat & 1;
          p0_transpose_item((ri ? F.w_i : F.w_a) + (size_t)h * 16384, 128, 128, F.WgT + (size_t)h * 256 * 128, 128, ri * 128, -LOG2E, scr, r & 7, F.lane); }
    }
    for (int m = gw; m < MM; m += NGW) rms_row_to_bf16(F.lane, F.mem + (size_t)m * D, F.mem_norm_g, F.MEMN + (size_t)m * D);
    __syncthreads();
    for (int k = F.tid; k < D; k += NWAVES * 64) {
        const GAS f32x4* src = (const GAS f32x4*)(F.w_in + (size_t)k * INW + 2048);
#pragma unroll
        for (int q = 0; q < 4; ++q) { const f32x4 v = src[q];
            *(LAS bf16*)(F.lds + (4 * q + 0) * WG1_STRIDE + 2 * k) = (bf16)f2bf(v.x); *(LAS bf16*)(F.lds + (4 * q + 1) * WG1_STRIDE + 2 * k) = (bf16)f2bf(v.y);
            *(LAS bf16*)(F.lds + (4 * q + 2) * WG1_STRIDE + 2 * k) = (bf16)f2bf(v.z); *(LAS bf16*)(F.lds + (4 * q + 3) * WG1_STRIDE + 2 * k) = (bf16)f2bf(v.w); }
    }
    __syncthreads();
    for (int r16 = gw; r16 < M / 16; r16 += NGW) p0_rows16(F, r16 * 16);
    __syncthreads();
}
typedef short s16x4 __attribute__((ext_vector_type(4)));
typedef __bf16 bf2_t __attribute__((ext_vector_type(2)));
__device__ __forceinline__ unsigned cvt2(float a, float b) { f32x2 v = {a, b}; return __builtin_bit_cast(unsigned, __builtin_convertvector(v, bf2_t)); }
__device__ __forceinline__ s16x4 lds_tr(const LAS unsigned char* p) { return __builtin_amdgcn_ds_read_tr16_b64_v4i16((LAS s16x4*)p); }
__device__ __forceinline__ bf16x8 cat8(s16x4 a, s16x4 b) { return __builtin_shufflevector(a, b, 0, 1, 2, 3, 4, 5, 6, 7); }
__device__ __forceinline__ void mul8_store(GAS v4u* dst, v4u a, v4u g) {
    v4u o;
    o.x = cvt2(bflo(a.x) * bflo(g.x), bfhi(a.x) * bfhi(g.x)); o.y = cvt2(bflo(a.y) * bflo(g.y), bfhi(a.y) * bfhi(g.y));
    o.z = cvt2(bflo(a.z) * bflo(g.z), bfhi(a.z) * bfhi(g.z)); o.w = cvt2(bflo(a.w) * bflo(g.w), bfhi(a.w) * bfhi(g.w));
    *dst = o;
}

__device__ __forceinline__ void xa_unit(Frame& F, int b, int h, int qb) {
    const int tid = F.tid, lane = F.lane, w = F.wave, fr = lane & 15, fq = lane >> 4;
    LAS unsigned char* Kt = F.lds + RING_OFF; LAS unsigned char* Vt = F.lds + RING_OFF + 65536;
    {
        v4u kr[8], vr[8];
#pragma unroll
        for (int i = 0; i < 8; ++i) { const int idx = tid + 512 * i, j = idx >> 4, ch = idx & 15;
            const GAS v4u* src = (const GAS v4u*)(F.KVM + (size_t)(b * MEM + j) * 1024 + 128 * h + 8 * ch); kr[i] = src[0]; vr[i] = src[64]; }
#pragma unroll
        for (int i = 0; i < 8; ++i) { const int idx = tid + 512 * i, j = idx >> 4, ch = idx & 15;
            *(LAS v4u*)(Kt + j * 256 + ((16 * ch) ^ ((j & 15) << 4))) = kr[i]; *(LAS v4u*)(Vt + j * 256 + ((16 * ch) ^ ((j & 7) << 5))) = vr[i]; }
    }
    const size_t row0 = (size_t)b * SEQ + 256 * qb + 32 * w;
    bf16x8 qf[2][4];
#pragma unroll
    for (int it = 0; it < 2; ++it)
#pragma unroll
        for (int ds = 0; ds < 4; ++ds) qf[it][ds] = *(const GAS bf16x8*)(F.PROJ + (row0 + 16 * it + fr) * NP + PC_XQ + 128 * h + 32 * ds + 8 * fq);
    __syncthreads();
    f32x4 acc[16][2];
    {
        int koff[4];
#pragma unroll
        for (int ds = 0; ds < 4; ++ds) koff[ds] = fr * 256 + ((64 * ds + 16 * fq) ^ (fr << 4));
#pragma unroll
        for (int jt = 0; jt < 16; ++jt) {
            acc[jt][0] = (f32x4){0.f, 0.f, 0.f, 0.f}; acc[jt][1] = (f32x4){0.f, 0.f, 0.f, 0.f};
#pragma unroll
            for (int ds = 0; ds < 4; ++ds) { const bf16x8 kf = *(const LAS bf16x8*)(Kt + jt * 4096 + koff[ds]);
                acc[jt][0] = __builtin_amdgcn_mfma_f32_16x16x32_bf16(kf, qf[0][ds], acc[jt][0], 0, 0, 0);
                acc[jt][1] = __builtin_amdgcn_mfma_f32_16x16x32_bf16(kf, qf[1][ds], acc[jt][1], 0, 0, 0); }
        }
    }
    constexpr float C = 0.08838834764831845f * LOG2E;
    unsigned pp[16][2][2]; float linv[2];
#pragma unroll
    for (int it = 0; it < 2; ++it) {
        float m = acc[0][it][0];
#pragma unroll
        for (int jt = 0; jt < 16; ++jt) m = fmaxf(fmaxf(m, fmaxf(acc[jt][it][0], acc[jt][it][1])), fmaxf(acc[jt][it][2], acc[jt][it][3]));
        m = fmaxf(m, __shfl_xor(m, 16)); m = fmaxf(m, __shfl_xor(m, 32));
        const float mc = m * C; float l = 0.f;
#pragma unroll
        for (int jt = 0; jt < 16; ++jt) {
            const float p0 = ex2(acc[jt][it][0] * C - mc), p1 = ex2(acc[jt][it][1] * C - mc), p2 = ex2(acc[jt][it][2] * C - mc), p3 = ex2(acc[jt][it][3] * C - mc);
            l += (p0 + p1) + (p2 + p3); pp[jt][it][0] = cvt2(p0, p1); pp[jt][it][1] = cvt2(p2, p3);
        }
        l += __shfl_xor(l, 16); l += __shfl_xor(l, 32);
        linv[it] = 1.0f / l;
    }
    __syncthreads();
    f32x4 o[2][8];
#pragma unroll
    for (int it = 0; it < 2; ++it)
#pragma unroll
        for (int dt = 0; dt < 8; ++dt) o[it][dt] = (f32x4){0.f, 0.f, 0.f, 0.f};
    {
        const int rho = 4 * (fq & 1) + (fr >> 2), vrow = (4 * fq + (fr >> 2)) * 256 + 8 * (fr & 3);
#pragma unroll
        for (int jp = 0; jp < 8; ++jp) {
            bf16x8 pf[2];
#pragma unroll
            for (int it = 0; it < 2; ++it) { v4u t; t.x = pp[2 * jp][it][0]; t.y = pp[2 * jp][it][1]; t.z = pp[2 * jp + 1][it][0]; t.w = pp[2 * jp + 1][it][1]; pf[it] = __builtin_bit_cast(bf16x8, t); }
#pragma unroll
            for (int dt = 0; dt < 8; ++dt) {
                const LAS unsigned char* va = Vt + vrow + ((dt ^ rho) << 5) + (2 * jp) * 4096;
                const bf16x8 vf = cat8(lds_tr(va), lds_tr(va + 4096));
                o[0][dt] = __builtin_amdgcn_mfma_f32_16x16x32_bf16(pf[0], vf, o[0][dt], 0, 0, 0);
                o[1][dt] = __builtin_amdgcn_mfma_f32_16x16x32_bf16(pf[1], vf, o[1][dt], 0, 0, 0);
            }
        }
    }
    LAS unsigned char* st = Kt + w * 8192;
#pragma unroll
    for (int it = 0; it < 2; ++it)
#pragma unroll
        for (int r = 0; r < 4; ++r) { const float li = __shfl(linv[it], 4 * fq + r);
#pragma unroll
            for (int dt = 0; dt < 8; ++dt) *(LAS bf16*)(st + (16 * it + 4 * fq + r) * 256 + (16 * dt + fr) * 2) = (bf16)f2bf(o[it][dt][r] * li); }
    LDS_WAIT(); asm volatile("" ::: "memory");
#pragma unroll
    for (int e = 0; e < 8; ++e) { const int id = lane + 64 * e, rr = id >> 4, ch = id & 15;
        const v4u a = *(const LAS v4u*)(st + rr * 256 + 16 * ch);
        const v4u g = *(const GAS v4u*)(F.PROJ + (row0 + rr) * NP + PC_G + 1536 + 128 * h + 8 * ch);
        mul8_store((GAS v4u*)(F.Y + (row0 + rr) * MIXW + 1536 + 128 * h + 8 * ch), a, g); }
    __syncthreads();
}
__device__ __forceinline__ void xa_phase(Frame& F, int first, int stride) {
    for (int u = first; u < NB * 4 * 16; u += stride) { const int qb = u & 15, bh = u >> 4; xa_unit(F, bh >> 2, bh & 3, qb); }
}
constexpr int LRU_TC = 256, LRU_NJ = SEQ / LRU_TC;
template <bool FINAL>
__device__ __forceinline__ void lru_unit(Frame& F, int b, int j, int h) {
    const int tid = F.tid, lane = F.lane, w = F.wave, fr = lane & 15, fq = lane >> 4;
    LAS unsigned char* Ut = F.lds + RING_OFF; LAS unsigned char* Ht = Ut + 65536;
    const size_t row0 = (size_t)b * SEQ + (size_t)j * LRU_TC;
    {
        const int ch = tid & 15, rg = tid >> 4, c0 = 128 * h + 8 * ch;
        float cw[4][8], cbv[8];
#pragma unroll
        for (int k = 0; k < 4; ++k) { const f32x4 a = *(const GAS f32x4*)(F.conv_w + k * D + c0), bq = *(const GAS f32x4*)(F.conv_w + k * D + c0 + 4);
            cw[k][0] = a.x; cw[k][1] = a.y; cw[k][2] = a.z; cw[k][3] = a.w; cw[k][4] = bq.x; cw[k][5] = bq.y; cw[k][6] = bq.z; cw[k][7] = bq.w; }
        { const f32x4 a = *(const GAS f32x4*)(F.conv_b + c0), bq = *(const GAS f32x4*)(F.conv_b + c0 + 4);
            cbv[0] = a.x; cbv[1] = a.y; cbv[2] = a.z; cbv[3] = a.w; cbv[4] = bq.x; cbv[5] = bq.y; cbv[6] = bq.z; cbv[7] = bq.w; }
        v4u xr[11];
#pragma unroll
        for (int i = 0; i < 11; ++i) { const int t = 8 * rg - 3 + i;
            if (j > 0 || t >= 0) xr[i] = *(const GAS v4u*)(F.PROJ + (size_t)((long)row0 + t) * NP + PC_U + c0); else xr[i] = (v4u){0u, 0u, 0u, 0u}; }
#pragma unroll
        for (int r = 0; r < 8; ++r) {
            float v[8];
#pragma unroll
            for (int e = 0; e < 8; ++e) v[e] = cbv[e];
#pragma unroll
            for (int k = 0; k < 4; ++k) { const v4u xx = xr[r + k];
                v[0] += cw[k][0] * bflo(xx.x); v[1] += cw[k][1] * bfhi(xx.x); v[2] += cw[k][2] * bflo(xx.y); v[3] += cw[k][3] * bfhi(xx.y);
                v[4] += cw[k][4] * bflo(xx.z); v[5] += cw[k][5] * bfhi(xx.z); v[6] += cw[k][6] * bflo(xx.w); v[7] += cw[k][7] * bfhi(xx.w); }
            const int t = 8 * rg + r; v4u o; o.x = cvt2(v[0], v[1]); o.y = cvt2(v[2], v[3]); o.z = cvt2(v[4], v[5]); o.w = cvt2(v[6], v[7]);
            *(LAS v4u*)(Ut + t * 256 + ((16 * ch) ^ ((t & 15) << 4))) = o;
        }
    }
    __syncthreads();
    {
        const int cl = 16 * w + fr, cg = 128 * h + cl;
        bf16x8 br[4], bi[4];
#pragma unroll
        for (int ks = 0; ks < 4; ++ks) { br[ks] = *(const GAS bf16x8*)(F.WgT + (size_t)(h * 256 + cl) * 128 + 32 * ks + 8 * fq); bi[ks] = *(const GAS bf16x8*)(F.WgT + (size_t)(h * 256 + 128 + cl) * 128 + 32 * ks + 8 * fq); }
        const float biasr = -LOG2E * F.b_a[cg], biasi = -LOG2E * F.b_i[cg];
        const float lm = F.lam[cg]; const float Kc = -8.0f * LOG2E * log1pf(expf(-lm));
        float S = 0.f, Prun = 1.f;
        if (FINAL) { for (int jj = 0; jj < j; ++jj) { const f32x2 ag = *(const GAS f32x2*)(F.LAGG + ((size_t)(b * LRU_NJ + jj) * D + cg) * 2); S = ag.x * S + ag.y; } }
        int aoff[4];
#pragma unroll
        for (int ks = 0; ks < 4; ++ks) aoff[ks] = fr * 256 + ((64 * ks + 16 * fq) ^ (fr << 4));
        for (int mt = 0; mt < LRU_TC / 16; ++mt) {
            f32x4 ar = (f32x4){biasr, biasr, biasr, biasr}, ai = (f32x4){biasi, biasi, biasi, biasi};
#pragma unroll
            for (int ks = 0; ks < 4; ++ks) { const bf16x8 af = *(const LAS bf16x8*)(Ut + mt * 4096 + aoff[ks]);
                ar = __builtin_amdgcn_mfma_f32_16x16x32_bf16(af, br[ks], ar, 0, 0, 0); ai = __builtin_amdgcn_mfma_f32_16x16x32_bf16(af, bi[ks], ai, 0, 0, 0); }
            float a[4], hh[4], p[4];
#pragma unroll
            for (int r = 0; r < 4; ++r) {
                const int t = 16 * mt + 4 * fq + r;
                const float u = bf2f(*(const LAS bf16*)(Ut + t * 256 + ((((cl >> 3) ^ (4 * fq + r)) << 4) + (cl & 7) * 2)));
                const float rg_ = rcp(1.0f + ex2(ar[r])), ig_ = rcp(1.0f + ex2(ai[r]));
                a[r] = ex2(Kc * rg_);
                const float mult = sqrtf(fmaxf(0.f, 1.0f - a[r] * a[r]));
                hh[r] = mult * (ig_ * u);
            }
            p[0] = a[0];
#pragma unroll
            for (int r = 1; r < 4; ++r) { hh[r] = a[r] * hh[r - 1] + hh[r]; p[r] = p[r - 1] * a[r]; }
            const float A0 = __shfl(p[3], fr), A1 = __shfl(p[3], fr + 16), A2 = __shfl(p[3], fr + 32), A3 = __shfl(p[3], fr + 48);
            const float H0 = __shfl(hh[3], fr), H1 = __shfl(hh[3], fr + 16), H2 = __shfl(hh[3], fr + 32), H3 = __shfl(hh[3], fr + 48);
            const float s1 = A0 * S + H0, s2 = A1 * s1 + H1, s3 = A2 * s2 + H2, sn = A3 * s3 + H3;
            const float sin_ = fq == 0 ? S : (fq == 1 ? s1 : (fq == 2 ? s2 : s3));
            if (FINAL) {
#pragma unroll
                for (int r = 0; r < 4; ++r) { const int t = 16 * mt + 4 * fq + r; *(LAS bf16*)(Ht + t * 256 + cl * 2) = (bf16)f2bf(hh[r] + p[r] * sin_); }
            } else Prun = Prun * ((A0 * A1) * (A2 * A3));
            S = sn;
        }
        if (!FINAL && fq == 0) *(GAS f32x2*)(F.LAGG + ((size_t)(b * LRU_NJ + j) * D + cg) * 2) = (f32x2){Prun, S};
    }
    if (FINAL) {
        __syncthreads();
#pragma unroll
        for (int e = 0; e < 8; ++e) { const int id = tid + 512 * e, t = id >> 4, ch = id & 15;
            const v4u a = *(const LAS v4u*)(Ht + t * 256 + 16 * ch);
            const v4u g = *(const GAS v4u*)(F.PROJ + (row0 + t) * NP + PC_G + 128 * h + 8 * ch);
            mul8_store((GAS v4u*)(F.Y + (row0 + t) * MIXW + 128 * h + 8 * ch), a, g); }
    }
    __syncthreads();
}
template <bool FINAL>
__device__ __forceinline__ void lru_phase(Frame& F, int first, int stride) {
    for (int u = first; u < NB * LRU_NJ * 8; u += stride) { const int h = u & 7, bj = u >> 3; lru_unit<FINAL>(F, bj / LRU_NJ, bj % LRU_NJ, h); }
}
constexpr int GLA_NG = 8, GLA_QD = 0, GLA_KD = 8192, GLA_VT = 16384, GLA_DEC = 32768, GLA_SSQ = 33024, GLA_OT = 35072, GLA_BUF = 51456, GLA_TOT = 2 * GLA_BUF;
constexpr size_t WS_GDEC = 40 * MiB;
template <bool FINAL>
__device__ __forceinline__ void gla_unit(Frame& F, int b, int h, int g) {
    const int tid = F.tid, lane = F.lane, w = F.wave, fr = lane & 15, fq = lane >> 4;
    const int unit = (b * 4 + h) * GLA_NG + g;
    const size_t rowg = (size_t)b * SEQ + 512 * g;
    float* GDEC = (float*)(F.ws + WS_GDEC);
    float wg[16];
#pragma unroll
    for (int r = 0; r < 16; ++r) wg[r] = F.w_g2[r * 256 + 64 * h + lane];
    const float bgk = F.b_g[64 * h + lane];
    const int rho = 4 * (fq & 1) + (fr >> 2);
    int off2[2];
#pragma unroll
    for (int ks = 0; ks < 2; ++ks) off2[ks] = fr * 128 + (((4 * ks + fq) ^ (fr & 7)) << 4);
    const int voff = (4 * fq + (fr >> 2)) * 256 + 32 * (w ^ rho) + 8 * (fr & 3);
    int koffT[4];
#pragma unroll
    for (int kt = 0; kt < 4; ++kt) koffT[kt] = (4 * fq + (fr >> 2)) * 128 + (((2 * kt + ((fr & 3) >> 1)) ^ rho) << 4) + 8 * (fr & 1);
    int qoff8[4];
#pragma unroll
    for (int kq = 0; kq < 4; ++kq) qoff8[kq] = fr * 128 + (((2 * kq + (fq >> 1)) ^ (fr & 7)) << 4) + 8 * (fq & 1);
    const float ngv = FINAL ? F.gla_norm_g[128 * h + 16 * w + fr] : 0.f;
    f32x4 S[4], dprod[4];
#pragma unroll
    for (int kt = 0; kt < 4; ++kt) { S[kt] = (f32x4){0.f, 0.f, 0.f, 0.f}; dprod[kt] = (f32x4){1.f, 1.f, 1.f, 1.f}; }
    if (FINAL) {
        for (int gp = 0; gp < g; ++gp) { const int up = (b * 4 + h) * GLA_NG + gp;
#pragma unroll
            for (int kt = 0; kt < 4; ++kt) { const f32x4 dd = *(const GAS f32x4*)(GDEC + (size_t)up * 64 + 16 * kt + 4 * fq);
#pragma unroll
                for (int r = 0; r < 4; ++r) S[kt][r] = dd[r] * S[kt][r] + F.GAGG[(size_t)up * 8192 + ((w * 4 + kt) * 4 + r) * 64 + lane]; } }
    }
    LAS float* TOT = (LAS float*)(F.lds + RING_OFF + GLA_TOT);
    for (int n = 0; n < 8; ++n) {
        LAS unsigned char* B = F.lds + RING_OFF + (n & 1) * GLA_BUF;
        const size_t row0 = rowg + 64 * n;
        {
            float c[8]; float run = 0.f;
            unsigned short qv[8], kv[8];
#pragma unroll
            for (int tt = 0; tt < 8; ++tt) { const size_t gr = row0 + 8 * w + tt;
                qv[tt] = F.PROJ[gr * NP + PC_Q + 64 * h + lane]; kv[tt] = F.PROJ[gr * NP + PC_K + 64 * h + lane]; }
            v4u vr[2];
#pragma unroll
            for (int e = 0; e < 2; ++e) { const int id = tid + 512 * e, j = id >> 4, ch = id & 15; vr[e] = *(const GAS v4u*)(F.PROJ + (row0 + j) * NP + PC_V + 128 * h + 8 * ch); }
#pragma unroll
            for (int tt = 0; tt < 8; ++tt) { const float* gl = F.GLR + (row0 + 8 * w + tt) * 16;
                float lg = bgk;
#pragma unroll
                for (int r = 0; r < 16; ++r) lg += gl[r] * wg[r];
                const float ls2 = fminf(lg, 0.f) * LOG2E - __builtin_amdgcn_logf(1.0f + ex2(-fabsf(lg) * LOG2E));
                run += ls2 * 0.0625f; c[tt] = run; }
            TOT[w * 64 + lane] = run;
            __syncthreads();
            float off = 0.f;
            for (int ww = 0; ww < w; ++ww) off += TOT[ww * 64 + lane];
#pragma unroll
            for (int tt = 0; tt < 8; ++tt) { const int t = 8 * w + tt; const float cum2 = off + c[tt];
                const float qd = bf2f(qv[tt]) * 0.125f * ex2(cum2), kd = bf2f(kv[tt]) * ex2(-cum2);
                const int o = t * 128 + ((((lane >> 3) ^ (t & 7)) << 4) + (lane & 7) * 2);
                *(LAS bf16*)(B + GLA_QD + o) = (bf16)f2bf(qd); *(LAS bf16*)(B + GLA_KD + o) = (bf16)f2bf(kd); }
            if (w == 7) *(LAS float*)(B + GLA_DEC + 4 * lane) = ex2(off + c[7]);
#pragma unroll
            for (int e = 0; e < 2; ++e) { const int id = tid + 512 * e, j = id >> 4, ch = id & 15; *(LAS v4u*)(B + GLA_VT + j * 256 + ((16 * ch) ^ ((j & 7) << 5))) = vr[e]; }
        }
        __syncthreads();
        bf16x8 vf[2];
#pragma unroll
        for (int jp = 0; jp < 2; ++jp) vf[jp] = cat8(lds_tr(B + GLA_VT + voff + (2 * jp) * 4096), lds_tr(B + GLA_VT + voff + (2 * jp + 1) * 4096));
        f32x4 o[4];
        if (FINAL) {
            bf16x8 kdf[4][2], qdf[4][2];
#pragma unroll
            for (int x = 0; x < 4; ++x)
#pragma unroll
                for (int ks = 0; ks < 2; ++ks) { kdf[x][ks] = *(const LAS bf16x8*)(B + GLA_KD + x * 2048 + off2[ks]); qdf[x][ks] = *(const LAS bf16x8*)(B + GLA_QD + x * 2048 + off2[ks]); }
            unsigned Xp[4][4][2];
#pragma unroll
            for (int jt = 0; jt < 4; ++jt)
#pragma unroll
                for (int it = 0; it < 4; ++it) {
                    if (it < jt) { Xp[jt][it][0] = 0u; Xp[jt][it][1] = 0u; continue; }
                    f32x4 a = (f32x4){0.f, 0.f, 0.f, 0.f};
#pragma unroll
                    for (int ks = 0; ks < 2; ++ks) a = __builtin_amdgcn_mfma_f32_16x16x32_bf16(kdf[jt][ks], qdf[it][ks], a, 0, 0, 0);
                    if (it == jt) {
#pragma unroll
                        for (int r = 0; r < 4; ++r) a[r] = (4 * fq + r > fr) ? 0.f : a[r]; }
                    Xp[jt][it][0] = cvt2(a[0], a[1]); Xp[jt][it][1] = cvt2(a[2], a[3]);
                }
            bf16x8 sf[2];
#pragma unroll
            for (int kp = 0; kp < 2; ++kp) { v4u t; t.x = cvt2(S[2 * kp][0], S[2 * kp][1]); t.y = cvt2(S[2 * kp][2], S[2 * kp][3]); t.z = cvt2(S[2 * kp + 1][0], S[2 * kp + 1][1]); t.w = cvt2(S[2 * kp + 1][2], S[2 * kp + 1][3]); sf[kp] = __builtin_bit_cast(bf16x8, t); }
#pragma unroll
            for (int it = 0; it < 4; ++it) {
                o[it] = (f32x4){0.f, 0.f, 0.f, 0.f};
#pragma unroll
                for (int jp = 0; jp < 2; ++jp) { if (2 * jp > it) continue;
                    v4u t; t.x = Xp[2 * jp][it][0]; t.y = Xp[2 * jp][it][1]; t.z = Xp[2 * jp + 1][it][0]; t.w = Xp[2 * jp + 1][it][1];
                    o[it] = __builtin_amdgcn_mfma_f32_16x16x32_bf16(__builtin_bit_cast(bf16x8, t), vf[jp], o[it], 0, 0, 0); }
#pragma unroll
                for (int kp = 0; kp < 2; ++kp) { const v2u a0 = *(const LAS v2u*)(B + GLA_QD + it * 2048 + qoff8[2 * kp]), a1 = *(const LAS v2u*)(B + GLA_QD + it * 2048 + qoff8[2 * kp + 1]);
                    v4u t; t.x = a0.x; t.y = a0.y; t.z = a1.x; t.w = a1.y;
                    o[it] = __builtin_amdgcn_mfma_f32_16x16x32_bf16(__builtin_bit_cast(bf16x8, t), sf[kp], o[it], 0, 0, 0); }
            }
        }
#pragma unroll
        for (int kt = 0; kt < 4; ++kt) {
            f32x4 kvacc = (f32x4){0.f, 0.f, 0.f, 0.f};
#pragma unroll
            for (int jp = 0; jp < 2; ++jp) { const bf16x8 af = cat8(lds_tr(B + GLA_KD + koffT[kt] + (2 * jp) * 2048), lds_tr(B + GLA_KD + koffT[kt] + (2 * jp + 1) * 2048));
                kvacc = __builtin_amdgcn_mfma_f32_16x16x32_bf16(af, vf[jp], kvacc, 0, 0, 0); }
            const f32x4 dd = *(const LAS f32x4*)(B + GLA_DEC + (16 * kt + 4 * fq) * 4);
            S[kt] = dd * (S[kt] + kvacc);
            if (!FINAL) dprod[kt] = dprod[kt] * dd;
        }
        if (FINAL) {
            float x8[8], x4[4], x2[2];
#pragma unroll
            for (int s = 0; s < 8; ++s) { const float lo = o[s >> 2][s & 3] * o[s >> 2][s & 3], hi = o[2 + (s >> 2)][s & 3] * o[2 + (s >> 2)][s & 3];
                const float mine = (fr & 8) ? hi : lo, oth = (fr & 8) ? lo : hi; x8[s] = mine + __shfl_xor(oth, 8); }
#pragma unroll
            for (int s = 0; s < 4; ++s) { const float mine = (fr & 4) ? x8[4 + s] : x8[s], oth = (fr & 4) ? x8[s] : x8[4 + s]; x4[s] = mine + __shfl_xor(oth, 4); }
#pragma unroll
            for (int s = 0; s < 2; ++s) { const float mine = (fr & 2) ? x4[2 + s] : x4[s], oth = (fr & 2) ? x4[s] : x4[2 + s]; x2[s] = mine + __shfl_xor(oth, 2); }
            const float mine = (fr & 1) ? x2[1] : x2[0], oth = (fr & 1) ? x2[0] : x2[1];
            const float tot = mine + __shfl_xor(oth, 1);
            *(LAS float*)(B + GLA_SSQ + (w * 64 + 16 * (fr >> 2) + 4 * fq + (fr & 3)) * 4) = tot;
            __syncthreads();
#pragma unroll
            for (int it = 0; it < 4; ++it) {
                f32x4 ss = (f32x4){0.f, 0.f, 0.f, 0.f};
#pragma unroll
                for (int ww = 0; ww < 8; ++ww) ss = ss + *(const LAS f32x4*)(B + GLA_SSQ + (ww * 64 + 16 * it + 4 * fq) * 4);
#pragma unroll
                for (int r = 0; r < 4; ++r) { const float rstd = 1.0f / sqrtf(ss[r] * (1.0f / 128.0f) + EPS);
                    *(LAS bf16*)(B + GLA_OT + (16 * it + 4 * fq + r) * 256 + (16 * w + fr) * 2) = (bf16)f2bf(o[it][r] * rstd * ngv); }
            }
            __syncthreads();
#pragma unroll
            for (int e = 0; e < 2; ++e) { const int id = tid + 512 * e, i = id >> 4, ch = id & 15;
                const v4u a = *(const LAS v4u*)(B + GLA_OT + i * 256 + 16 * ch);
                const v4u gt = *(const GAS v4u*)(F.PROJ + (row0 + i) * NP + PC_G + 1024 + 128 * h + 8 * ch);
                mul8_store((GAS v4u*)(F.Y + (row0 + i) * MIXW + 1024 + 128 * h + 8 * ch), a, gt); }
        }
    }
    if (!FINAL) {
#pragma unroll
        for (int kt = 0; kt < 4; ++kt) {
#pragma unroll
            for (int r = 0; r < 4; ++r) F.GAGG[(size_t)unit * 8192 + ((w * 4 + kt) * 4 + r) * 64 + lane] = S[kt][r];
            if (w == 0 && fr == 0) *(GAS f32x4*)(GDEC + (size_t)unit * 64 + 16 * kt + 4 * fq) = dprod[kt];
        }
    }
    __syncthreads();
}
template <bool FINAL>
__device__ __forceinline__ void gla_phase(Frame& F, int first, int stride) {
    for (int u = first; u < NB * 4 * GLA_NG; u += stride) { const int g = u & 7, bh = u >> 3; gla_unit<FINAL>(F, bh >> 2, bh & 3, g); }
}
#ifndef MK_N_LAUNCHES
#define MK_N_LAUNCHES 1
#endif
struct Args { const float* in[18]; float* out; unsigned char* ws; int ph_lo, ph_hi; };
constexpr int N_PHASES = 6;
__global__ void __launch_bounds__(NWAVES * 64, 2) mega(Args args) {
    extern __shared__ __attribute__((aligned(16))) unsigned char lds[];
    Frame F;
    F.lds = (LAS unsigned char*)lds;
    F.MISC = (volatile LAS unsigned*)(F.lds + MISC_OFF);
    F.tid = threadIdx.x; F.lane = F.tid & 63; F.wave = __builtin_amdgcn_readfirstlane(F.tid >> 6);
    F.G = gridDim.x; { const int bx = blockIdx.x; F.vcu = (F.G % 8 == 0) ? (bx % 8) * (F.G / 8) + bx / 8 : bx; }
    unsigned char* ws = args.ws; F.ws = ws;
    F.ctl = (gu32*)(ws + WS_CTL);
    F.x = args.in[0]; F.mem = args.in[1]; F.norm_g = args.in[2]; F.mem_norm_g = args.in[3]; F.w_in = args.in[4]; F.conv_w = args.in[5]; F.conv_b = args.in[6];
    F.w_a = args.in[7]; F.b_a = args.in[8]; F.w_i = args.in[9]; F.b_i = args.in[10]; F.lam = args.in[11]; F.w_g2 = args.in[12]; F.b_g = args.in[13]; F.gla_norm_g = args.in[14];
    F.w_mem_kv = args.in[15]; F.w_out = args.in[16]; F.final_g = args.in[17]; F.out = args.out;
    F.WinT = (bf16*)(ws + WS_WIN); F.WoutT = (bf16*)(ws + WS_WOUT); F.WkvT = (bf16*)(ws + WS_WKV); F.WgT = (bf16*)(ws + WS_WG);
    F.GLR = (float*)(ws + WS_GLR); F.MEMN = (bf16*)(ws + WS_MEMN); F.KVM = (bf16*)(ws + WS_KVM); F.RSTD = (float*)(ws + WS_RSTD);
    F.LAGG = (float*)(ws + WS_LAGG); F.GAGG = (float*)(ws + WS_GAGG); F.XG = (bf16*)(ws + WS_A); F.Y = (bf16*)(ws + WS_A); F.PROJ = (bf16*)(ws + WS_PROJ);
    for (int u = F.tid; u < (LDS_BYTES - LDSCTL_OFF) / 4; u += NWAVES * 64) ((LAS unsigned*)(F.lds + LDSCTL_OFF))[u] = 0u;
    __syncthreads();
    const int lo = args.ph_lo, hi = args.ph_hi;
    XcdBarrier bar; bar.bar = (unsigned*)(F.ctl + CW_BAR); bar.x = 0; bar.st = nullptr;
    if (hi - lo > 1) bar = xcd_barrier_post((unsigned*)(F.ctl + CW_BAR), F.MISC + 8);
#define IN(k) (lo <= (k) && (k) < hi)
#define BOTH(k) (IN(k) && IN((k) + 1))
#define GRID_BAR() xcd_barrier(bar)

    if (IN(0)) { p0_prologue(F); if (BOTH(0)) GRID_BAR(); }

    if (IN(1)) {
        pg8::Gemm g{F.XG, F.WinT, M, NP, D}; pg8::StaticOrder S; S.init(M, NP, F.G, (int)blockIdx.x);
        pg8::EpiProj E{F.PROJ, NP, F.RSTD, PC_G / 256};
        pg8::gemm_phase<pg8::EpiProj, pg8::StaticOrder, true, true>(F.lds + RING_OFF, g, S, E);
        if (BOTH(1)) GRID_BAR();
    }
    if (IN(2)) {
        { pg8::Gemm g{F.MEMN, F.WkvT, MM, D, D}; pg8::StaticOrder S; S.init(MM, D, F.G, (int)blockIdx.x);
          pg8::EpiProj E{F.KVM, D, nullptr, 1 << 20};
          pg8::gemm_phase<pg8::EpiProj, pg8::StaticOrder, true, true>(F.lds + RING_OFF, g, S, E); }
        gla_phase<false>(F, F.vcu, F.G); lru_phase<false>(F, F.vcu, F.G); if (BOTH(2)) GRID_BAR(); }
    if (IN(3)) { gla_phase<true>(F, F.vcu, F.G); lru_phase<true>(F, F.vcu, F.G); xa_phase(F, F.vcu, F.G); if (BOTH(3)) GRID_BAR(); }
    if (IN(4)) {
        pg8::Gemm g{F.Y, F.WoutT, M, D, MIXW}; pg8::StaticOrder S; S.init(M, D, F.G, (int)blockIdx.x);
        pg8::EpiRes E{F.x, F.out, D};
        pg8::gemm_phase<pg8::EpiRes, pg8::StaticOrder, true, true>(F.lds + RING_OFF, g, S, E);
        if (BOTH(4)) GRID_BAR();
    }
    if (IN(5)) {
        const int gw = F.vcu * NWAVES + F.wave, NGW = F.G * NWAVES;
        for (int m = gw; m < M; m += NGW) { GAS f32x4* xr = (GAS f32x4*)(F.out + (size_t)m * D) + F.lane; const GAS f32x4* gr = (const GAS f32x4*)F.final_g + F.lane;
            f32x4 v[4]; float ss = 0.f;
#pragma unroll
            for (int jj = 0; jj < 4; ++jj) { v[jj] = xr[64 * jj]; ss += (v[jj].x * v[jj].x + v[jj].y * v[jj].y) + (v[jj].z * v[jj].z + v[jj].w * v[jj].w); }
            const float rstd = 1.f / sqrtf(wave_sum(ss) * (1.f / D) + EPS);
#pragma unroll
            for (int jj = 0; jj < 4; ++jj) xr[64 * jj] = v[jj] * rstd * gr[64 * jj]; }
    }
#undef IN
#undef BOTH
}

extern "C" void kernel_launch(void* const* d_in, const int* in_sizes, int n_in, void* d_out, int out_size, void* d_ws, size_t ws_size, hipStream_t stream) {
    static int grid = 0;
    if (grid == 0) {
        if (n_in != 18 || in_sizes[0] != M * D || out_size != M * D || ws_size < WS_END) { fprintf(stderr, "kernel_launch: unexpected shapes / workspace (n_in %d, ws %zu)\n", n_in, ws_size); grid = -1; return; }
        int dev = 0, cus = 0;
        if (hipGetDevice(&dev) != hipSuccess || hipDeviceGetAttribute(&cus, hipDeviceAttributeMultiprocessorCount, dev) != hipSuccess) { grid = -1; return; }
        if (hipFuncSetAttribute((const void*)mega, hipFuncAttributeMaxDynamicSharedMemorySize, LDS_BYTES) != hipSuccess) { fprintf(stderr, "kernel_launch: hipFuncSetAttribute failed\n"); grid = -1; return; }
        (void)hipGetLastError();
        grid = cus;
    }
    if (grid < 0) return;
    (void)hipMemsetAsync((char*)d_ws + WS_CTL, 0, CTL_ZERO_BYTES, stream);
    Args a{};
    for (int i = 0; i < 18; ++i) a.in[i] = (const float*)d_in[i];
    a.out = (float*)d_out; a.ws = (unsigned char*)d_ws;
#if MK_N_LAUNCHES == 1
    a.ph_lo = 0; a.ph_hi = N_PHASES; hipLaunchKernelGGL(mega, dim3(grid), dim3(NWAVES * 64), LDS_BYTES, stream, a);
#else
    for (int ph = 0; ph < N_PHASES; ++ph) { a.ph_lo = ph; a.ph_hi = ph + 1; hipLaunchKernelGGL(mega, dim3(grid), dim3(NWAVES * 64), LDS_BYTES, stream, a); }
#endif
}
```
